# Optimizing an MI355X kernel written in HIP

```python
import jax, jax.numpy as jnp
from jax import lax
import numpy as np

D_MODEL = 1024
BATCH = 4
SEQ = 4096
DEPTH = 1

N_META = 16
CHUNK = 64
PAD = CHUNK - N_META
MIX_WIDTH = D_MODEL
HGRN_WIDTH = MIX_WIDTH // 2
HGRN_HEAD_DIM = 128
HGRN_HEADS = HGRN_WIDTH // HGRN_HEAD_DIM
GLA_WIDTH = MIX_WIDTH - HGRN_WIDTH
GLA_HEADS = 4
GLA_V_DIM = GLA_WIDTH // GLA_HEADS
GLA_K_DIM = GLA_V_DIM // 2
GLA_GATE_RANK = 16
GLA_GATE_NORMALIZER = 16.0
FFN_HIDDEN = ((8 * D_MODEL + 3 * 256 - 1) // (3 * 256)) * 256
NORM_EPS = 1e-6

SPLIT_SIZES = (
    HGRN_WIDTH, HGRN_WIDTH, HGRN_WIDTH, HGRN_WIDTH,
    GLA_HEADS * GLA_K_DIM, GLA_HEADS * GLA_K_DIM,
    GLA_WIDTH, GLA_WIDTH,
    GLA_GATE_RANK,
)
SPLIT_POINTS = tuple(int(s) for s in np.cumsum(SPLIT_SIZES)[:-1])
IN_COLS = int(sum(SPLIT_SIZES))

kernel_name = "hymba_hgrn2_gla_hybrid_block"


def rmsnorm(x, g):
    xf = x.astype(jnp.float32)
    y = xf * lax.rsqrt(jnp.mean(xf * xf, axis=-1, keepdims=True) + NORM_EPS)
    return (y * g.astype(jnp.float32)).astype(x.dtype)


def chunked_gated_linear_recurrence(q, k, v, log_a):
    B, T, H, Dk = q.shape
    Dv = v.shape[-1]
    n = T // CHUNK

    def blk(t):
        return t.astype(jnp.float32).reshape(B, n, CHUNK, H, t.shape[-1]).transpose(0, 3, 1, 2, 4)

    q, k, v, g = blk(q), blk(k), blk(v), blk(log_a)
    b = jnp.cumsum(g, axis=3)
    b_last = b[:, :, :, -1:, :]
    q_d = q * jnp.exp(b)
    k_d = k * jnp.exp(-b)
    k_s = k * jnp.exp(b_last - b)

    causal = jnp.tril(jnp.ones((CHUNK, CHUNK), dtype=bool))
    scores = jnp.einsum('bhncd,bhnsd->bhncs', q_d, k_d)
    scores = jnp.where(causal, scores, 0.0)
    o_intra = jnp.einsum('bhncs,bhnse->bhnce', scores, v)

    d_state = jnp.einsum('bhnsd,bhnse->nbhde', k_s, v)
    chunk_decay = jnp.exp(b_last[:, :, :, 0, :]).transpose(2, 0, 1, 3)

    def step(S, inp):
        dec, ds = inp
        return dec[..., None] * S + ds, S

    _, S_start = lax.scan(step, jnp.zeros((B, H, Dk, Dv), jnp.float32), (chunk_decay, d_state))
    o_inter = jnp.einsum('bhncd,nbhde->bhnce', q_d, S_start)
    return (o_intra + o_inter).transpose(0, 2, 3, 1, 4).reshape(B, T, H, Dv)


def run_group(q, k, v, log_a):
    pad = lambda t: jnp.pad(t, ((0, 0), (PAD, 0), (0, 0), (0, 0)))
    o = chunked_gated_linear_recurrence(pad(q), pad(k), pad(v), pad(log_a))
    return o[:, PAD:]


def hybrid_mixer(u, w_in, w_gla_gate_up, b_gla_gate, lb, hgrn_norm_g, gla_norm_g, w_out):
    B, T, _ = u.shape
    proj = u @ w_in
    hq, hf, hi, hg, gq, gk, gv, gg, ga = jnp.split(proj, SPLIT_POINTS, axis=-1)

    f = lb + (1.0 - lb) * jax.nn.sigmoid(hf.astype(jnp.float32))
    hgrn_shape = (B, T, HGRN_HEADS, HGRN_HEAD_DIM)
    o_h = run_group(jax.nn.silu(hq).reshape(hgrn_shape),
                    (1.0 - f).reshape(hgrn_shape),
                    hi.reshape(hgrn_shape),
                    jnp.log(f).reshape(hgrn_shape))
    o_h = rmsnorm(o_h.astype(u.dtype), hgrn_norm_g) * jax.nn.silu(hg.reshape(hgrn_shape))

    gate_logits = (ga @ w_gla_gate_up + b_gla_gate).astype(jnp.float32)
    log_alpha = jax.nn.log_sigmoid(gate_logits) / GLA_GATE_NORMALIZER
    k_shape = (B, T, GLA_HEADS, GLA_K_DIM)
    v_shape = (B, T, GLA_HEADS, GLA_V_DIM)
    o_g = run_group(gq.reshape(k_shape) * (GLA_K_DIM ** -0.5),
                    gk.reshape(k_shape),
                    gv.reshape(v_shape),
                    log_alpha.reshape(k_shape))
    o_g = rmsnorm(o_g.astype(u.dtype), gla_norm_g) * jax.nn.silu(gg.reshape(v_shape))

    o = jnp.concatenate([o_h.reshape(B, T, HGRN_WIDTH), o_g.reshape(B, T, GLA_WIDTH)], axis=-1)
    return o @ w_out


def swiglu(u, w_ffn_in, w_ffn_out):
    gate, up = jnp.split(u @ w_ffn_in, 2, axis=-1)
    return (jax.nn.silu(gate) * up) @ w_ffn_out


def setup_inputs(seed: int = 0) -> dict:
    key = jax.random.key(seed)
    ks = jax.random.split(key, 16)
    f32 = jnp.float32
    nrm = lambda k, shape, scale: jax.random.normal(k, shape, f32) * scale
    return {
        "x": nrm(ks[0], (BATCH, SEQ, D_MODEL), 1.0),
        "meta_tokens": nrm(ks[1], (N_META, D_MODEL), 1.0),
        "lb_table": nrm(ks[2], (DEPTH + 1, HGRN_WIDTH), 0.1),
        "norm_mix_g": 1.0 + nrm(ks[3], (DEPTH, D_MODEL), 0.01),
        "w_in": nrm(ks[4], (DEPTH, D_MODEL, IN_COLS), D_MODEL ** -0.5),
        "w_gla_gate_up": nrm(ks[5], (DEPTH, GLA_GATE_RANK, GLA_HEADS * GLA_K_DIM), GLA_GATE_RANK ** -0.5),
        "b_gla_gate": nrm(ks[6], (DEPTH, GLA_HEADS * GLA_K_DIM), 0.01),
        "hgrn_norm_g": 1.0 + nrm(ks[7], (DEPTH, HGRN_HEAD_DIM), 0.01),
        "gla_norm_g": 1.0 + nrm(ks[8], (DEPTH, GLA_V_DIM), 0.01),
        "w_out": nrm(ks[9], (DEPTH, MIX_WIDTH, D_MODEL), MIX_WIDTH ** -0.5),
        "norm_ffn_g": 1.0 + nrm(ks[10], (DEPTH, D_MODEL), 0.01),
        "w_ffn_in": nrm(ks[11], (DEPTH, D_MODEL, 2 * FFN_HIDDEN), D_MODEL ** -0.5),
        "w_ffn_out": nrm(ks[12], (DEPTH, FFN_HIDDEN, D_MODEL), FFN_HIDDEN ** -0.5),
        "norm_final_g": 1.0 + nrm(ks[13], (D_MODEL,), 0.01),
    }


def reference(x, meta_tokens, lb_table, norm_mix_g, w_in, w_gla_gate_up, b_gla_gate,
              hgrn_norm_g, gla_norm_g, w_out, norm_ffn_g, w_ffn_in, w_ffn_out, norm_final_g):
    B = x.shape[0]
    meta = jnp.broadcast_to(meta_tokens.astype(x.dtype)[None], (B, N_META, D_MODEL))
    h = jnp.concatenate([meta, x], axis=1)

    lb_all = jnp.cumsum(jax.nn.softmax(lb_table.astype(jnp.float32), axis=0), axis=0)

    for l in range(DEPTH):
        u = rmsnorm(h, norm_mix_g[l])
        h = h + hybrid_mixer(u, w_in[l], w_gla_gate_up[l], b_gla_gate[l], lb_all[l],
                             hgrn_norm_g[l], gla_norm_g[l], w_out[l])
        u = rmsnorm(h, norm_ffn_g[l])
        h = h + swiglu(u, w_ffn_in[l], w_ffn_out[l])

    h = rmsnorm(h, norm_final_g)
    return h[:, N_META:]
```

```cpp
#include <hip/hip_runtime.h>
#include <cstdio>
#include <cstdint>
namespace pg8 {
#define PG8_LAS __attribute__((address_space(3)))
typedef unsigned short bf16_t;
typedef short bf16x8 __attribute__((ext_vector_type(8)));
typedef float f32x4 __attribute__((ext_vector_type(4)));
typedef unsigned u32x4 __attribute__((ext_vector_type(4)));
constexpr int BM = 256, BK = 64, HALF = 128, HTB = HALF * BK * 2  , STAGE_BYTES = 8 * HTB, NXCD = 8, WGM = 8;

__host__ __device__ __forceinline__ int lds_byte(int r, int c) { const int st = (r >> 4) * 2 + (c >> 5), rr = r & 15, cc = c & 31, ob = rr * 64 + cc * 2; return st * 1024 + (ob ^ (((ob >> 9) & 1) << 5)); }
__host__ __device__ __forceinline__ void stage_rc(int b, int& R, int& C) { const int st = b / 1024, sb = b % 1024, swz = sb ^ (((sb >> 9) & 1) << 5); R = (st >> 1) * 16 + swz / 64; C = (st & 1) * 32 + (swz % 64) / 2; }
__host__ __device__ __forceinline__ int perm32(int rho) { const int n = rho >> 4, i = rho & 15; return 8 * (i >> 2) + 4 * n + (i & 3); }

struct Unit { int pm, pn; };
struct Gemm { const bf16_t* A; const bf16_t* Bt; int M, N, K; };

struct StaticOrder {
    int nM, nN, nwg, G, c;
    __host__ __device__ void init(int M, int N, int G_, int c_) { nM = M / BM; nN = N / BM; nwg = nM * nN; G = G_; c = c_; }
    __host__ __device__ bool next(int i, Unit& u) const {
        const long L = (long)i * G + c; if (L >= nwg) return false;
        int wgid = (int)L; { const int q = nwg / NXCD, r = nwg % NXCD, xcd = wgid % NXCD, off = wgid / NXCD; wgid = (xcd < r ? xcd * (q + 1) : r * (q + 1) + (xcd - r) * q) + off; }
        const int nig = WGM * nN, gid = wgid / nig, fm = gid * WGM, gsz = (nM - fm) < WGM ? (nM - fm) : WGM;
        u.pm = fm + ((wgid % nig) % gsz); u.pn = (wgid % nig) / gsz; return true;
    }
    __device__ __forceinline__ void a_ready(const Unit&) const {}
    __device__ __forceinline__ void done(const Unit&) const {}
};
__device__ __forceinline__ unsigned cvt_pk_bf16(float lo, float hi) { unsigned r; asm volatile("v_cvt_pk_bf16_f32 %0, %1, %2" : "=v"(r) : "v"(lo), "v"(hi)); return r; }
template <class Epi, class Sched, bool ALIGN_EPI = false, bool SP2 = false>
__device__ __forceinline__ void gemm_phase(PG8_LAS unsigned char* lds, const Gemm g, const Sched& S, const Epi& E) {
    const int tid = threadIdx.x, wid = __builtin_amdgcn_readfirstlane(tid >> 6), lane = tid & 63, wr = wid >> 2, wc = wid & 3, fr = lane & 15, fq = lane >> 4;
    const int K = g.K, nt = K / BK;
    unsigned voffA[2], voffB[2];
#pragma unroll
    for (int i = 0; i < 2; ++i) { int R, C; stage_rc(tid * 16 + i * 8192, R, C); const int Rb = Epi::PERM ? ((R & ~31) + perm32(R & 31)) : R;
        voffA[i] = (unsigned)(R * K + C) * 2u; voffB[i] = (unsigned)(Rb * K + C) * 2u; }
    const size_t kstep = (size_t)(BK * 2);
    const size_t hstep = (size_t)HALF * K * 2;
    const size_t tstep = 2 * hstep;
    const unsigned ldsw = (unsigned)wid * 1024u;
    const int aoff = lds_byte(wr * 64 + fr, fq * 8), boff = lds_byte(wc * 32 + fr, fq * 8);
#define PG8_SA(b, h) (((b) * 2 + (h)) * HTB)
#define PG8_SB(b, h) ((4 + (b) * 2 + (h)) * HTB)
#define PG8_STAGE(bufoff, gbase, voff) do { _Pragma("unroll") for (int _i = 0; _i < 2; ++_i) \
        __builtin_amdgcn_global_load_lds((const unsigned*)((const char*)(gbase) + (voff)[_i]), (PG8_LAS unsigned*)(lds + (bufoff) + ldsw + _i * 8192), 16, 0, 0); } while (0)
#define PG8_LDA(dst, b, h) do { _Pragma("unroll") for (int m = 0; m < 4; ++m) _Pragma("unroll") for (int k = 0; k < 2; ++k) dst[m][k] = *(const PG8_LAS bf16x8*)(lds + PG8_SA(b, h) + aoff + m * 2048 + k * 1024); } while (0)
#define PG8_LDB(dst, b, h) do { _Pragma("unroll") for (int n = 0; n < 2; ++n) _Pragma("unroll") for (int k = 0; k < 2; ++k) dst[n][k] = *(const PG8_LAS bf16x8*)(lds + PG8_SB(b, h) + boff + n * 2048 + k * 1024); } while (0)
#define PG8_MMA(ai, bj, At, Bt) do { __builtin_amdgcn_s_setprio(1); _Pragma("unroll") for (int m = 0; m < 4; ++m) _Pragma("unroll") for (int n = 0; n < 2; ++n) _Pragma("unroll") for (int k = 0; k < 2; ++k) \
        acc[ai][bj][m][n] = __builtin_amdgcn_mfma_f32_16x16x32_bf16(Bt[n][k], At[m][k], acc[ai][bj][m][n], 0, 0, 0); __builtin_amdgcn_s_setprio(0); } while (0)
#define PG8_WAIT_V(n) asm volatile("s_waitcnt vmcnt(" #n ")" ::: "memory")
#define PG8_WAIT_L(n) asm volatile("s_waitcnt lgkmcnt(" #n ")" ::: "memory")
#define PG8_BAR __builtin_amdgcn_s_barrier()
#define PG8_SCHED __builtin_amdgcn_sched_barrier(0)
    Unit cur, nxt; int ui = 0;
    if (!S.next(0, cur)) return;
    f32x4 acc[2][2][4][2];
#pragma unroll
    for (int a = 0; a < 2; ++a)
#pragma unroll
        for (int b = 0; b < 2; ++b)
#pragma unroll
            for (int m = 0; m < 4; ++m)
#pragma unroll
                for (int n = 0; n < 2; ++n) acc[a][b][m][n] = (f32x4){0.f, 0.f, 0.f, 0.f};
    bf16x8 At[4][2], B0[2][2], B1[2][2];
    const char* cA = (const char*)g.A + (size_t)cur.pm * tstep; const char* cB = (const char*)g.Bt + (size_t)cur.pn * tstep;
    S.a_ready(cur);
    if constexpr (SP2) {
        PG8_STAGE(PG8_SB(0, 0), cB, voffB); PG8_STAGE(PG8_SB(0, 1), cB + hstep, voffB); PG8_STAGE(PG8_SA(0, 0), cA, voffA); PG8_STAGE(PG8_SA(0, 1), cA + hstep, voffA);
        if (wr == 1) PG8_BAR;
        PG8_WAIT_V(2); PG8_BAR;
        PG8_STAGE(PG8_SB(1, 0), cB + kstep, voffB); PG8_STAGE(PG8_SA(1, 0), cA + kstep, voffA); PG8_STAGE(PG8_SB(1, 1), cB + hstep + kstep, voffB);
        PG8_WAIT_V(6); PG8_BAR;
    } else {
        PG8_STAGE(PG8_SB(0, 0), cB, voffB); PG8_STAGE(PG8_SA(0, 0), cA, voffA); PG8_STAGE(PG8_SB(0, 1), cB + hstep, voffB); PG8_STAGE(PG8_SA(0, 1), cA + hstep, voffA);
        if (wr == 1) PG8_BAR;
        PG8_WAIT_V(4); PG8_BAR;
        PG8_STAGE(PG8_SB(1, 0), cB + kstep, voffB); PG8_STAGE(PG8_SA(1, 0), cA + kstep, voffA); PG8_STAGE(PG8_SB(1, 1), cB + hstep + kstep, voffB);
        PG8_WAIT_V(6); PG8_BAR;
    }
    for (;;) {
        const bool has_next = S.next(ui + 1, nxt);
        const char* nA = has_next ? (const char*)g.A + (size_t)nxt.pm * tstep : cA; const char* nB = has_next ? (const char*)g.Bt + (size_t)nxt.pn * tstep : cB;
        for (int t = 0; t < nt; t += 2) {
            const bool last = (t == nt - 2);
            const char* a1 = cA + (size_t)(t + 1) * kstep;
            const char* a2 = last ? nA : cA + (size_t)(t + 2) * kstep; const char* b2 = last ? nB : cB + (size_t)(t + 2) * kstep;
            const char* a3 = a2 + kstep; const char* b3 = b2 + kstep;
            if (last && has_next) S.a_ready(nxt);
            if constexpr (SP2) {
            PG8_LDB(B0, 0, 0); PG8_LDB(B1, 0, 1); PG8_SCHED; PG8_LDA(At, 0, 0); PG8_STAGE(PG8_SA(1, 1), a1 + hstep, voffA);
            PG8_WAIT_V(8); PG8_WAIT_L(0); PG8_BAR; PG8_MMA(0, 0, At, B0); PG8_MMA(0, 1, At, B1); PG8_BAR; PG8_SCHED;
            PG8_LDA(At, 0, 1); PG8_STAGE(PG8_SB(0, 0), b2, voffB); PG8_STAGE(PG8_SB(0, 1), b2 + hstep, voffB); PG8_STAGE(PG8_SA(0, 0), a2, voffA);
            PG8_WAIT_V(8); PG8_WAIT_L(0); PG8_BAR; PG8_MMA(1, 0, At, B0); PG8_MMA(1, 1, At, B1); PG8_BAR; PG8_SCHED;
            PG8_LDB(B0, 1, 0); PG8_LDB(B1, 1, 1); PG8_SCHED; PG8_LDA(At, 1, 0); PG8_STAGE(PG8_SA(0, 1), a2 + hstep, voffA);
            PG8_WAIT_V(8); PG8_WAIT_L(0); PG8_BAR; PG8_MMA(0, 0, At, B0); PG8_MMA(0, 1, At, B1); PG8_BAR; PG8_SCHED;
            PG8_LDA(At, 1, 1); PG8_STAGE(PG8_SB(1, 0), b3, voffB); PG8_STAGE(PG8_SB(1, 1), b3 + hstep, voffB); PG8_STAGE(PG8_SA(1, 0), a3, voffA);
            PG8_WAIT_V(8); PG8_WAIT_L(0); PG8_BAR; PG8_MMA(1, 0, At, B0); PG8_MMA(1, 1, At, B1); PG8_BAR; PG8_SCHED;
            } else {
            PG8_LDB(B0, 0, 0); PG8_SCHED; PG8_LDA(At, 0, 0); PG8_STAGE(PG8_SA(1, 1), a1 + hstep, voffA);
            PG8_WAIT_L(8); PG8_BAR; PG8_WAIT_L(0); PG8_MMA(0, 0, At, B0); PG8_BAR; PG8_SCHED;
            PG8_LDB(B1, 0, 1); PG8_STAGE(PG8_SB(0, 0), b2, voffB);
            PG8_BAR; PG8_WAIT_L(0); PG8_MMA(0, 1, At, B1); PG8_BAR;
            PG8_LDA(At, 0, 1); PG8_STAGE(PG8_SA(0, 0), a2, voffA);
            PG8_BAR; PG8_WAIT_L(0); PG8_MMA(1, 0, At, B0); PG8_BAR; PG8_SCHED;
            PG8_STAGE(PG8_SB(0, 1), b2 + hstep, voffB);
            PG8_WAIT_V(6); PG8_BAR; PG8_MMA(1, 1, At, B1); PG8_BAR;
            PG8_LDB(B0, 1, 0); PG8_SCHED; PG8_LDA(At, 1, 0); PG8_STAGE(PG8_SA(0, 1), a2 + hstep, voffA);
            PG8_WAIT_L(8); PG8_BAR; PG8_WAIT_L(0); PG8_MMA(0, 0, At, B0); PG8_BAR; PG8_SCHED;
            PG8_LDB(B1, 1, 1); PG8_STAGE(PG8_SB(1, 0), b3, voffB);
            PG8_BAR; PG8_WAIT_L(0); PG8_MMA(0, 1, At, B1); PG8_BAR;
            PG8_LDA(At, 1, 1); PG8_STAGE(PG8_SA(1, 0), a3, voffA);
            PG8_BAR; PG8_WAIT_L(0); PG8_MMA(1, 0, At, B0); PG8_BAR; PG8_SCHED;
            PG8_STAGE(PG8_SB(1, 1), b3 + hstep, voffB);
            PG8_WAIT_V(6); PG8_BAR; PG8_MMA(1, 1, At, B1); PG8_BAR;
            }
        }
        if constexpr (ALIGN_EPI) { if (wr == 0) PG8_BAR; }
        if constexpr (!Epi::AFTER_DRAIN) { E(acc, cur, wr, wc, fr, fq); S.done(cur); }
        if (!has_next) break;
#pragma unroll
        for (int a = 0; a < 2; ++a)
#pragma unroll
            for (int b = 0; b < 2; ++b)
#pragma unroll
                for (int m = 0; m < 4; ++m)
#pragma unroll
                    for (int n = 0; n < 2; ++n) acc[a][b][m][n] = (f32x4){0.f, 0.f, 0.f, 0.f};
        cur = nxt; cA = nA; cB = nB; ++ui;
        if constexpr (ALIGN_EPI) { if (wr == 1) PG8_BAR; }
    }
    PG8_WAIT_V(0);
    if constexpr (!ALIGN_EPI) { if (wr == 0) PG8_BAR; }
    PG8_BAR;
    if constexpr (Epi::AFTER_DRAIN) { E.fused(acc, cur, wr, wc, fr, fq, lds, wid, lane); S.done(cur); }
#undef PG8_SA
#undef PG8_SB
#undef PG8_STAGE
#undef PG8_LDA
#undef PG8_LDB
#undef PG8_MMA
#undef PG8_WAIT_V
#undef PG8_WAIT_L
#undef PG8_BAR
#undef PG8_SCHED
}
}

constexpr int NWAVES = 8;
#ifndef MK_N_LAUNCHES
#define MK_N_LAUNCHES 8
#endif
constexpr int N_LAUNCHES = MK_N_LAUNCHES;
constexpr int NPHASE = 8;

constexpr int D = 1024, BATCH = 4, SEQ = 4096, NMETA = 16;
constexpr int MTOK = BATCH * SEQ;
constexpr int MP1 = 16640;
constexpr int NPROJ = 3584;
constexpr int NIN = 3840;
constexpr int NGLOG = 768;
constexpr int FFH = 2816, NF1 = 2 * FFH;
constexpr int WIN_COLS = 3600;
constexpr float EPS = 1e-6f;
constexpr int NSC = 8;

constexpr size_t MiB = 1u << 20;
constexpr size_t WS_CTL = 0, CTL_ZERO_BYTES = 1 * MiB;
constexpr size_t WS_WIN = 1 * MiB;
constexpr size_t WS_WO = 9 * MiB;
constexpr size_t WS_W1 = 11 * MiB;
constexpr size_t WS_W2 = 22 * MiB;
constexpr size_t WS_RSTD0 = 28 * MiB;
constexpr size_t WS_LB = 28 * MiB + 128 * 1024;
constexpr size_t WS_SSQ1 = 28 * MiB + 256 * 1024;
constexpr size_t WS_SSQ2 = 28 * MiB + 512 * 1024;
constexpr size_t WS_DLOC = 28 * MiB + 768 * 1024;
constexpr size_t WS_SLOC = 30 * MiB;
constexpr size_t WS_XB = 44 * MiB;
constexpr size_t WS_GLOG = 77 * MiB;
constexpr size_t WS_OG = 102 * MiB;
constexpr size_t WS_PROJ = 134 * MiB;
constexpr size_t WS_END = 248 * MiB;
static_assert(WS_WIN + (size_t)NIN * D * 2 <= WS_WO && WS_WO + (size_t)D * D * 2 <= WS_W1 && WS_W1 + (size_t)NF1 * D * 2 <= WS_W2 && WS_W2 + (size_t)D * FFH * 2 <= WS_RSTD0, "weights map");
static_assert(WS_SLOC + (size_t)32 * 7 * 16 * 64 * 16 * 4 <= WS_XB && WS_XB + (size_t)MP1 * D * 2 <= WS_GLOG && WS_GLOG + (size_t)MP1 * NGLOG * 2 <= WS_OG && WS_OG + (size_t)MTOK * D * 2 <= WS_PROJ && WS_PROJ + (size_t)MP1 * NPROJ * 2 <= WS_END, "d_ws map");
constexpr int CW_BAR = 4096;

constexpr int RING_OFF = 0, RING_BYTES = 131072;
constexpr int LDSCTL_OFF = RING_BYTES, MISC_OFF = LDSCTL_OFF + 320;
constexpr int LDS_BYTES = 147456;

#define GAS __attribute__((address_space(1)))
#define LAS __attribute__((address_space(3)))
typedef unsigned short bf16;
typedef unsigned v4u __attribute__((ext_vector_type(4)));
typedef float f32x4 __attribute__((ext_vector_type(4)));
typedef short bf16x8 __attribute__((ext_vector_type(8)));
typedef GAS unsigned gu32;
typedef GAS unsigned long long gu64;
#define RLX_AGENT __ATOMIC_RELAXED, __HIP_MEMORY_SCOPE_AGENT
#define LDS_WAIT() asm volatile("s_waitcnt lgkmcnt(0)" ::: "memory")
#define VM_WAIT() asm volatile("s_waitcnt vmcnt(0)" ::: "memory")
__device__ __forceinline__ unsigned long long rt() { return __builtin_amdgcn_s_memrealtime(); }
__device__ __forceinline__ unsigned f2bf(float f) { unsigned u = __builtin_bit_cast(unsigned, f); return (u + 0x7fffu + ((u >> 16) & 1u)) >> 16; }
__device__ __forceinline__ unsigned pk2(float lo, float hi) { return f2bf(lo) | (f2bf(hi) << 16); }
#define XB_TMO      128
#define XB_XCNT(j)  (256  + 64 * (j))
#define XB_XSUB(j)  (1280 + 64 * (j))
#define XB_XGEN(j)  (2304 + 64 * (j))
#define XB_TOP      3328
#define XB_TOPGEN   3392
#define XCD_BAR_WORDS 3456
#define XB_SPIN_CAP (1u << 18)

__device__ __forceinline__ unsigned xb_ld(unsigned* p)              { return __hip_atomic_load(p, __ATOMIC_RELAXED, __HIP_MEMORY_SCOPE_AGENT); }
__device__ __forceinline__ unsigned xb_add(unsigned* p, unsigned v) { return __hip_atomic_fetch_add(p, v, __ATOMIC_RELAXED, __HIP_MEMORY_SCOPE_AGENT); }
__device__ __forceinline__ unsigned xb_xcc_id() { return (unsigned)__builtin_amdgcn_s_getreg((3 << 11) | 20) & 0xFu; }
#define XB_SPIN(cond, bar) do { unsigned _sp = 0; while (cond) { __builtin_amdgcn_s_sleep(1); \
    if ((++_sp & 255u) == 0u) { if (xb_ld(&(bar)[XB_TMO])) break; if (_sp > XB_SPIN_CAP) { atomicAdd(&(bar)[XB_TMO], 1u); break; } } } } while (0)

struct XcdBarrier {
    unsigned* bar; unsigned x;
    volatile LAS unsigned* st;
};

__device__ __forceinline__ XcdBarrier xcd_barrier_post(unsigned* bar, volatile LAS unsigned* st) {
    XcdBarrier b; b.bar = bar; b.x = xb_xcc_id(); b.st = st;
    if (threadIdx.x == 0) (void)xb_add(&bar[XB_XCNT(b.x)], 1u);
    return b;
}
__device__ __forceinline__ void xcd_barrier_complete(unsigned* bar, unsigned x, unsigned& nloc, unsigned& nx) {
    const unsigned G = gridDim.x * gridDim.y * gridDim.z;
    unsigned sum, cnt, mine, sp = 0u;
    for (;;) {
        sum = 0u; cnt = 0u; mine = 0u;
#pragma unroll
        for (unsigned j = 0; j < 16; ++j) { const unsigned c = xb_ld(&bar[XB_XCNT(j)]); sum += c; cnt += (c > 0u) ? 1u : 0u; mine = (j == x) ? c : mine; }
        if (sum == G) break;
        __builtin_amdgcn_s_sleep(1);
        if ((++sp & 255u) == 0u) { if (xb_ld(&bar[XB_TMO])) break; if (sp > XB_SPIN_CAP) { atomicAdd(&bar[XB_TMO], 1u); break; } }
    }
    nloc = mine > 0u ? mine : 1u; nx = cnt > 0u ? cnt : 1u;
}

__device__ __forceinline__ void xcd_barrier(const XcdBarrier& b) {
    asm volatile("s_waitcnt vmcnt(0)" ::: "memory");
    __syncthreads();
    if (threadIdx.x == 0) {
        unsigned* bar = b.bar;
        __builtin_amdgcn_s_waitcnt(0);
        unsigned nloc = b.st[0], nx = b.st[1];
        if (nloc == 0u) { xcd_barrier_complete(bar, b.x, nloc, nx); b.st[0] = nloc; b.st[1] = nx; }
        const unsigned old = xb_add(&bar[XB_XSUB(b.x)], 1u);
        const unsigned gen = old / nloc;
        if (old + 1u == (gen + 1u) * nloc) {
            __builtin_amdgcn_fence(__ATOMIC_RELEASE, "agent");
            asm volatile("s_waitcnt vmcnt(0)" ::: "memory");
            const unsigned og = xb_add(&bar[XB_TOP], 1u);
            const unsigned tg = og / nx;
            if (og + 1u == (tg + 1u) * nx) xb_add(&bar[XB_TOPGEN], 1u);
            else XB_SPIN(xb_ld(&bar[XB_TOPGEN]) == tg, bar);
            __builtin_amdgcn_fence(__ATOMIC_ACQUIRE, "agent");
            xb_add(&bar[XB_XGEN(b.x)], 1u);
            asm volatile("s_waitcnt vmcnt(0)" ::: "memory");
        } else {
            XB_SPIN(xb_ld(&bar[XB_XGEN(b.x)]) == gen, bar);
            __builtin_amdgcn_fence(__ATOMIC_ACQUIRE, "agent");
            asm volatile("s_waitcnt vmcnt(0)" ::: "memory");
        }
    }
    __syncthreads();
}

typedef float f32x16 __attribute__((ext_vector_type(16)));
typedef short v4i16_t __attribute__((ext_vector_type(4)));
typedef unsigned u32x2 __attribute__((ext_vector_type(2)));
struct Frame {
    LAS unsigned char* lds;
    volatile LAS unsigned* MISC;
    gu32* ctl;
    int tid, lane, wave, G;
    const float *x, *meta, *lbt, *g_mix, *w_in, *w_up, *b_gate, *hgrn_ng, *gla_ng, *w_out, *g_ffn, *w_f1, *w_f2, *g_fin;
    float* out;
    bf16 *WinT, *WoT, *W1T, *W2T, *XB, *PROJ, *GLOG, *OG, *H1B, *HID;
    float *RSTD0, *LB, *SSQ1, *SSQ2, *DLOC, *SLOC;
};

__device__ __forceinline__ float wave_sum(float v) {
#pragma unroll
    for (int o = 1; o < 64; o <<= 1) v += __shfl_xor(v, o);
    return v;
}
__device__ __forceinline__ float bf2f(unsigned u) { return __uint_as_float(u << 16); }
__device__ __forceinline__ float silu_f(float v) { return v * __builtin_amdgcn_rcpf(1.0f + __expf(-v)); }

struct EpiProj {
    static constexpr bool PERM = true, AFTER_DRAIN = false;
    bf16* proj; bf16* glog; const float* rstd0; const float* lb; const float* bgate;
    __device__ __forceinline__ void operator()(const pg8::f32x4 (&acc)[2][2][4][2], const pg8::Unit& u, int wr, int wc, int fr, int fq) const {
        const int pn = u.pn, row0 = u.pm * 256 + wr * 64 + fr, ct = wc * 32 + 8 * fq;
        if (pn == 2 || pn == 3) {
            float oml[2][8];
#pragma unroll
            for (int bj = 0; bj < 2; ++bj)
#pragma unroll
                for (int e = 0; e < 8; ++e) oml[bj][e] = 1.0f - lb[(pn - 2) * 256 + bj * 128 + ct + e];
#pragma unroll
            for (int ai = 0; ai < 2; ++ai)
#pragma unroll
                for (int m = 0; m < 4; ++m) { const int r = row0 + ai * 128 + m * 16; const float rs = rstd0[r];
#pragma unroll
                    for (int bj = 0; bj < 2; ++bj) { const int cc = (pn - 2) * 256 + bj * 128 + ct; float kv[8], gv[8];
#pragma unroll
                        for (int e = 0; e < 8; ++e) { const float v = acc[ai][bj][m][e >> 2][e & 3] * rs; const float k = oml[bj][e] * __builtin_amdgcn_rcpf(1.0f + __expf(v)); kv[e] = k; gv[e] = __logf(1.0f - k); }
                        v4u wk, wg; wk.x = pk2(kv[0], kv[1]); wk.y = pk2(kv[2], kv[3]); wk.z = pk2(kv[4], kv[5]); wk.w = pk2(kv[6], kv[7]);
                        wg.x = pk2(gv[0], gv[1]); wg.y = pk2(gv[2], gv[3]); wg.z = pk2(gv[4], gv[5]); wg.w = pk2(gv[6], gv[7]);
                        *(GAS v4u*)(proj + (size_t)r * NPROJ + 512 + cc) = wk; *(GAS v4u*)(glog + (size_t)r * NGLOG + cc) = wg; } }
        } else if (pn == 14) {
            float bg[2][8];
#pragma unroll
            for (int bj = 0; bj < 2; ++bj)
#pragma unroll
                for (int e = 0; e < 8; ++e) bg[bj][e] = bgate[bj * 128 + ct + e];
#pragma unroll
            for (int ai = 0; ai < 2; ++ai)
#pragma unroll
                for (int m = 0; m < 4; ++m) { const int r = row0 + ai * 128 + m * 16; const float rs = rstd0[r];
#pragma unroll
                    for (int bj = 0; bj < 2; ++bj) { float gv[8];
#pragma unroll
                        for (int e = 0; e < 8; ++e) { const float xx = acc[ai][bj][m][e >> 2][e & 3] * rs + bg[bj][e]; gv[e] = -(fmaxf(-xx, 0.0f) + __logf(1.0f + __expf(-fabsf(xx)))) * 0.0625f; }
                        v4u wg; wg.x = pk2(gv[0], gv[1]); wg.y = pk2(gv[2], gv[3]); wg.z = pk2(gv[4], gv[5]); wg.w = pk2(gv[6], gv[7]);
                        *(GAS v4u*)(glog + (size_t)r * NGLOG + 512 + bj * 128 + ct) = wg; } }
        } else {
            const bool is_silu = (pn <= 1) || pn == 6 || pn == 7 || pn >= 12;
            const float sc = (pn == 8) ? 0.125f : 1.0f;
#pragma unroll
            for (int ai = 0; ai < 2; ++ai)
#pragma unroll
                for (int m = 0; m < 4; ++m) { const int r = row0 + ai * 128 + m * 16; const float rs = rstd0[r] * sc;
#pragma unroll
                    for (int bj = 0; bj < 2; ++bj) { float ov[8];
#pragma unroll
                        for (int e = 0; e < 8; ++e) ov[e] = acc[ai][bj][m][e >> 2][e & 3] * rs;
                        if (is_silu) {
#pragma unroll
                            for (int e = 0; e < 8; ++e) ov[e] = silu_f(ov[e]); }
                        v4u wv; wv.x = pk2(ov[0], ov[1]); wv.y = pk2(ov[2], ov[3]); wv.z = pk2(ov[4], ov[5]); wv.w = pk2(ov[6], ov[7]);
                        *(GAS v4u*)(proj + (size_t)r * NPROJ + pn * 256 + bj * 128 + ct) = wv; } }
        }
    }
};
struct EpiRes {
    static constexpr bool PERM = false, AFTER_DRAIN = true;
    const float* base; float* out; bf16* outb; float* ssq;
    __device__ __forceinline__ void fused(pg8::f32x4 (&acc)[2][2][4][2], const pg8::Unit& u, int wr, int wc, int fr, int fq, PG8_LAS unsigned char* lds, int wid, int lane) const {
        PG8_LAS float* P = (PG8_LAS float*)lds;
        const int col0 = u.pn * 256 + wc * 32 + 4 * fq;
#pragma unroll
        for (int ai = 0; ai < 2; ++ai)
#pragma unroll
            for (int m = 0; m < 4; ++m) { const int rl = ai * 128 + wr * 64 + m * 16 + fr; const size_t off = (size_t)(u.pm * 256 + rl) * D + col0; float ss = 0.f;
#pragma unroll
                for (int bj = 0; bj < 2; ++bj)
#pragma unroll
                    for (int n = 0; n < 2; ++n) { const size_t c = off + bj * 128 + n * 16; const pg8::f32x4 hv = *(const GAS pg8::f32x4*)(base + c) + acc[ai][bj][m][n];
                        *(GAS pg8::f32x4*)(out + c) = hv; ss += (hv[0] * hv[0] + hv[1] * hv[1]) + (hv[2] * hv[2] + hv[3] * hv[3]);
                        if (outb) { u32x2 wv; wv.x = pk2(hv[0], hv[1]); wv.y = pk2(hv[2], hv[3]); *(GAS u32x2*)(outb + c) = wv; } }
                ss += __shfl_xor(ss, 16); ss += __shfl_xor(ss, 32);
                if (fq == 0) P[rl * 4 + wc] = ss;
                asm volatile("" ::: "memory"); }
        asm volatile("s_waitcnt lgkmcnt(0)" ::: "memory"); __builtin_amdgcn_s_barrier(); asm volatile("" ::: "memory");
        const int t = wid * 64 + lane;
        if (t < 256) { const pg8::f32x4 p = *(const PG8_LAS pg8::f32x4*)(P + t * 4); ssq[(size_t)(u.pm * 256 + t) * 4 + u.pn] = (p[0] + p[1]) + (p[2] + p[3]); }
    }
};
struct EpiSwiglu {
    static constexpr bool PERM = true, AFTER_DRAIN = false;
    bf16* hid; const float* ssq;
    __device__ __forceinline__ void operator()(const pg8::f32x4 (&acc)[2][2][4][2], const pg8::Unit& u, int wr, int wc, int fr, int fq) const {
        const int row0 = u.pm * 256 + wr * 64 + fr, col = u.pn * 128 + wc * 32 + 8 * fq;
#pragma unroll
        for (int ai = 0; ai < 2; ++ai)
#pragma unroll
            for (int m = 0; m < 4; ++m) { const int r = row0 + ai * 128 + m * 16; const pg8::f32x4 s4 = *(const GAS pg8::f32x4*)(ssq + (size_t)r * 4);
                const float rs = 1.0f / sqrtf(((s4[0] + s4[1]) + (s4[2] + s4[3])) * (1.0f / D) + EPS); float hv[8];
#pragma unroll
                for (int e = 0; e < 8; ++e) hv[e] = silu_f(acc[ai][0][m][e >> 2][e & 3] * rs) * (acc[ai][1][m][e >> 2][e & 3] * rs);
                v4u wv; wv.x = pk2(hv[0], hv[1]); wv.y = pk2(hv[2], hv[3]); wv.z = pk2(hv[4], hv[5]); wv.w = pk2(hv[6], hv[7]);
                *(GAS v4u*)(hid + (size_t)r * FFH + col) = wv; }
    }
};

__device__ __forceinline__ void p0_tr_item(const float* W, int N, int K, bf16* WT, int k0, int n0, int drow0, const float* scale, LAS float* scr, int lane) {
#pragma unroll 8
    for (int i = 0; i < 32; ++i) { const int kk = 2 * i + (lane >> 5); float v = W[(size_t)(k0 + kk) * N + n0 + (lane & 31)]; if (scale) v *= scale[k0 + kk]; scr[kk * 33 + (lane & 31)] = v; }
    LDS_WAIT(); asm volatile("" ::: "memory");
    const int c = lane & 7;
#pragma unroll
    for (int j = 0; j < 4; ++j) { const int n = (lane >> 3) + 8 * j; const LAS float* s = scr + (8 * c) * 33 + n;
        v4u o; o.x = pk2(s[0 * 33], s[1 * 33]); o.y = pk2(s[2 * 33], s[3 * 33]); o.z = pk2(s[4 * 33], s[5 * 33]); o.w = pk2(s[6 * 33], s[7 * 33]);
        *(GAS v4u*)(WT + (size_t)(drow0 + n) * K + k0 + 8 * c) = o; }
    LDS_WAIT(); asm volatile("" ::: "memory");
}
__device__ __forceinline__ void p0_weff_item(const float* Win, const float* Wup, const float* gmix, bf16* WT, int k0, int n0, LAS float* scr, int lane) {
    float wu[16];
#pragma unroll
    for (int r = 0; r < 16; ++r) wu[r] = Wup[r * 256 + n0 + (lane & 31)];
#pragma unroll 4
    for (int i = 0; i < 32; ++i) { const int kk = 2 * i + (lane >> 5); const float* wr_ = Win + (size_t)(k0 + kk) * WIN_COLS + NPROJ; float s = 0.f;
#pragma unroll
        for (int r = 0; r < 16; ++r) s += wr_[r] * wu[r];
        scr[kk * 33 + (lane & 31)] = s * gmix[k0 + kk]; }
    LDS_WAIT(); asm volatile("" ::: "memory");
    const int c = lane & 7;
#pragma unroll
    for (int j = 0; j < 4; ++j) { const int n = (lane >> 3) + 8 * j; const LAS float* s = scr + (8 * c) * 33 + n;
        v4u o; o.x = pk2(s[0 * 33], s[1 * 33]); o.y = pk2(s[2 * 33], s[3 * 33]); o.z = pk2(s[4 * 33], s[5 * 33]); o.w = pk2(s[6 * 33], s[7 * 33]);
        *(GAS v4u*)(WT + (size_t)(NPROJ + n0 + n) * D + k0 + 8 * c) = o; }
    LDS_WAIT(); asm volatile("" ::: "memory");
}
__device__ __forceinline__ void p0_prologue(Frame& F) {
    LAS float* scr = (LAS float*)(F.lds + RING_OFF + F.wave * 16384);
    const int gw = blockIdx.x * NWAVES + F.wave, NGW = F.G * NWAVES, lane = F.lane;
    constexpr int I_A = 16 * (NPROJ / 32), I_B = 16 * 8, I_C = 16 * 32, I_D = 16 * (NF1 / 32), I_E = (FFH / 64) * 32;
    constexpr int NITEMS = I_A + I_B + I_C + I_D + I_E;
    for (int it = gw; it < NITEMS; it += NGW) {
        int r = it;
        if (r < I_A) { const int nb = r % (NPROJ / 32), kb = r / (NPROJ / 32); p0_tr_item(F.w_in, WIN_COLS, D, F.WinT, 64 * kb, 32 * nb, 32 * nb, F.g_mix, scr, lane); continue; } r -= I_A;
        if (r < I_B) { const int nb = r % 8, kb = r / 8; p0_weff_item(F.w_in, F.w_up, F.g_mix, F.WinT, 64 * kb, 32 * nb, scr, lane); continue; } r -= I_B;
        if (r < I_C) { const int nb = r % 32, kb = r / 32; p0_tr_item(F.w_out, D, D, F.WoT, 64 * kb, 32 * nb, 32 * nb, nullptr, scr, lane); continue; } r -= I_C;
        if (r < I_D) { const int nb = r % (NF1 / 32), kb = r / (NF1 / 32); const int n0 = 32 * nb; const int up = n0 >= FFH ? 1 : 0, cc = n0 - up * FFH;
            p0_tr_item(F.w_f1, NF1, D, F.W1T, 64 * kb, n0, 256 * (cc / 128) + 128 * up + (cc % 128), F.g_ffn, scr, lane); continue; } r -= I_D;
        { const int nb = r % 32, kb = r / 32; p0_tr_item(F.w_f2, D, FFH, F.W2T, 64 * kb, 32 * nb, 32 * nb, nullptr, scr, lane); }
    }
    for (int m = gw; m < MP1; m += NGW) {
        GAS unsigned long long* o8 = (GAS unsigned long long*)(F.XB + (size_t)m * D) + lane;
        if (m < MTOK + NMETA) {
            const float* xrow = m < MTOK ? F.x + (size_t)m * D : F.meta + (size_t)(m - MTOK) * D;
            const GAS f32x4* xr = (const GAS f32x4*)xrow + lane; f32x4 v[4]; float s = 0.f;
#pragma unroll
            for (int j = 0; j < 4; ++j) { v[j] = xr[64 * j]; s += (v[j].x * v[j].x + v[j].y * v[j].y) + (v[j].z * v[j].z + v[j].w * v[j].w); }
            s = wave_sum(s);
            if (lane == 0) F.RSTD0[m] = 1.0f / sqrtf(s * (1.0f / D) + EPS);
#pragma unroll
            for (int j = 0; j < 4; ++j) o8[64 * j] = (unsigned long long)pk2(v[j].x, v[j].y) | ((unsigned long long)pk2(v[j].z, v[j].w) << 32);
        } else {
            if (lane == 0) F.RSTD0[m] = 0.f;
#pragma unroll
            for (int j = 0; j < 4; ++j) o8[64 * j] = 0ull;
        }
    }
    if (blockIdx.x == 0) { const int d = F.tid; F.LB[d] = 1.0f / (1.0f + __expf(F.lbt[512 + d] - F.lbt[d])); }
}

constexpr int R_LD = 272, R_QI = 0, R_KI = 17408, R_GI = 34816, R_VI = 52224, R_ST = 69632, R_PI = 104448, R_DEC = 113664, R_SEG = 114176, R_END = 116224;
constexpr int R_PLD = 144, R_OLD = 528;
static_assert(R_END <= RING_BYTES && 64 * R_OLD <= R_GI, "recurrence LDS map");
#define MFMA32(a, b, c) __builtin_amdgcn_mfma_f32_32x32x16_bf16((a), (b), (c), 0, 0, 0)
__device__ __forceinline__ int crow(int i, int h) { return (i & 3) + 8 * (i >> 2) + 4 * h; }
__device__ __forceinline__ bf16x8 tr_frag(LAS unsigned char* base, int ks, int cblk, int lane) {
    const int h = lane >> 5, blk = (lane >> 4) & 1, q = (lane & 15) >> 2, p = lane & 3;
    LAS unsigned char* a = base + (ks * 16 + 8 * h + q) * R_LD + (cblk * 32 + 16 * blk + 4 * p) * 2;
    const v4i16_t lo = __builtin_amdgcn_ds_read_tr16_b64_v4i16((LAS v4i16_t*)a);
    const v4i16_t hi = __builtin_amdgcn_ds_read_tr16_b64_v4i16((LAS v4i16_t*)(a + 4 * R_LD));
    return __builtin_shufflevector(lo, hi, 0, 1, 2, 3, 4, 5, 6, 7);
}
__device__ __forceinline__ int grow_of(int b, int c, int row) { return c == 0 ? (row >= 64 - NMETA ? MTOK + row - (64 - NMETA) : -1) : b * SEQ + (c - 1) * 64 + row; }
__device__ __forceinline__ v4u ld16_or_zero(const bf16* p, int gr, size_t ld, int col) {
    const int grc = gr < 0 ? 0 : gr; v4u v = *(const GAS v4u*)(p + (size_t)grc * ld + col);
    if (gr < 0) v = (v4u){0u, 0u, 0u, 0u};
    return v;
}

template <int DK, bool OUT>
__device__ __forceinline__ void rec_unit(Frame& F, const int grp, const int bh, const int j) {
    constexpr int NQ = DK / 64;
    constexpr int NSEG = 512 / DK, TPS = 64 / NSEG, LOGDK = (DK == 128 ? 7 : 6), LOGPR = (DK == 128 ? 4 : 3);
    LAS unsigned char* lds = F.lds + RING_OFF;
    const int tid = F.tid, lane = F.lane, w = F.wave, r = lane & 31, h = lane >> 5;
    const int b = bh >> 2, hd = bh & 3;
    const int qcol = grp ? 2048 + hd * 64 : hd * 128, kcol = grp ? 2304 + hd * 64 : 512 + hd * 128, vcol = grp ? 2560 + hd * 128 : 1024 + hd * 128;
    const int gtcol = grp ? 3072 + hd * 128 : 1536 + hd * 128, gcol = grp ? 512 + hd * 64 : hd * 128, ocol = grp * 512 + hd * 128;
    const float* ng = grp ? F.gla_ng : F.hgrn_ng;
    const int gidx = grp * 16 + bh, dvb = w & 3, dkb0 = (w >> 2) * NQ;
    f32x16 sacc[NQ];
#pragma unroll
    for (int t = 0; t < NQ; ++t)
#pragma unroll
        for (int i = 0; i < 16; ++i) sacc[t][i] = 0.f;

    if (OUT) {
        for (int i = 0; i < j; ++i) {
            if (tid < DK) *(LAS float*)(lds + R_DEC + tid * 4) = F.DLOC[(size_t)(gidx * 7 + i) * 128 + tid];
            const float* sl = F.SLOC + (size_t)(gidx * 7 + i) * (16 * 64 * 16);
            f32x16 sv[NQ];
#pragma unroll
            for (int t = 0; t < NQ; ++t) sv[t] = *(const GAS f32x16*)(sl + (size_t)((w * 2 + t) * 64 + lane) * 16);
            __syncthreads();
#pragma unroll
            for (int t = 0; t < NQ; ++t)
#pragma unroll
                for (int i2 = 0; i2 < 16; ++i2) sacc[t][i2] = sacc[t][i2] * *(LAS float*)(lds + R_DEC + ((dkb0 + t) * 32 + crow(i2, h)) * 4) + sv[t][i2];
            __syncthreads();
        }
#pragma unroll
        for (int t = 0; t < NQ; ++t)
#pragma unroll
            for (int g = 0; g < 4; ++g) { u32x2 wv; wv.x = pk2(sacc[t][4 * g], sacc[t][4 * g + 1]); wv.y = pk2(sacc[t][4 * g + 2], sacc[t][4 * g + 3]);
                *(LAS u32x2*)(lds + R_ST + (dvb * 32 + r) * R_LD + ((dkb0 + t) * 32 + 8 * g + 4 * h) * 2) = wv; }
    }
    float bsum = 0.f;
    const int c_first = (j == 0) ? 0 : 8 * j + 1, c_last = 8 * j + 8;
    v4u rq[NQ], rk[NQ], rg[NQ], rv[2];
#pragma unroll
    for (int i = 0; i < NQ; ++i) { const int p = tid + 512 * i, row = p >> LOGPR, ch = p & ((1 << LOGPR) - 1), gr = grow_of(b, c_first, row);
        if (OUT) rq[i] = ld16_or_zero(F.PROJ, gr, NPROJ, qcol + ch * 8);
        rk[i] = ld16_or_zero(F.PROJ, gr, NPROJ, kcol + ch * 8); rg[i] = ld16_or_zero(F.GLOG, gr, NGLOG, gcol + ch * 8); }
#pragma unroll
    for (int i = 0; i < 2; ++i) { const int p = tid + 512 * i, row = p >> 4, ch = p & 15; rv[i] = ld16_or_zero(F.PROJ, grow_of(b, c_first, row), NPROJ, vcol + ch * 8); }

    for (int c = c_first; c <= c_last; ++c) {
        const bool do_out = OUT && (c != 0);
#pragma unroll
        for (int i = 0; i < NQ; ++i) { const int p = tid + 512 * i, row = p >> LOGPR, ch = p & ((1 << LOGPR) - 1);
            if (OUT) *(LAS v4u*)(lds + R_QI + row * R_LD + ch * 16) = rq[i];
            *(LAS v4u*)(lds + R_KI + row * R_LD + ch * 16) = rk[i]; *(LAS v4u*)(lds + R_GI + row * R_LD + ch * 16) = rg[i]; }
#pragma unroll
        for (int i = 0; i < 2; ++i) { const int p = tid + 512 * i, row = p >> 4, ch = p & 15; *(LAS v4u*)(lds + R_VI + row * R_LD + ch * 16) = rv[i]; }
        v4u gt[2] = {(v4u){0u, 0u, 0u, 0u}, (v4u){0u, 0u, 0u, 0u}};
        if (do_out) { const int gr = grow_of(b, c, tid >> 3); const bf16* gp = F.PROJ + (size_t)gr * NPROJ + gtcol + (tid & 7) * 16; gt[0] = *(const GAS v4u*)gp; gt[1] = *(const GAS v4u*)(gp + 8); }
        if (c < c_last) {
#pragma unroll
            for (int i = 0; i < NQ; ++i) { const int p = tid + 512 * i, row = p >> LOGPR, ch = p & ((1 << LOGPR) - 1), gr = grow_of(b, c + 1, row);
                if (OUT) rq[i] = ld16_or_zero(F.PROJ, gr, NPROJ, qcol + ch * 8);
                rk[i] = ld16_or_zero(F.PROJ, gr, NPROJ, kcol + ch * 8); rg[i] = ld16_or_zero(F.GLOG, gr, NGLOG, gcol + ch * 8); }
#pragma unroll
            for (int i = 0; i < 2; ++i) { const int p = tid + 512 * i, row = p >> 4, ch = p & 15; rv[i] = ld16_or_zero(F.PROJ, grow_of(b, c + 1, row), NPROJ, vcol + ch * 8); }
        }
        __syncthreads();
        const int d = tid & (DK - 1), seg = tid >> LOGDK;
        float bl[TPS]; { float run = 0.f;
#pragma unroll
            for (int i = 0; i < TPS; ++i) { run += bf2f(*(LAS unsigned short*)(lds + R_GI + (seg * TPS + i) * R_LD + d * 2)); bl[i] = run; }
            *(LAS float*)(lds + R_SEG + (seg * DK + d) * 4) = run; }
        __syncthreads();
        { float off = 0.f, tot = 0.f;
#pragma unroll
            for (int s = 0; s < NSEG; ++s) { const float v = *(LAS float*)(lds + R_SEG + (s * DK + d) * 4); tot += v; off += (s < seg) ? v : 0.f; }
#pragma unroll
            for (int i = 0; i < TPS; ++i) { const int tok = seg * TPS + i; const float bb = off + bl[i];
                const float kraw = bf2f(*(LAS unsigned short*)(lds + R_KI + tok * R_LD + d * 2));
                if (do_out) { const float qraw = bf2f(*(LAS unsigned short*)(lds + R_QI + tok * R_LD + d * 2));
                    *(LAS unsigned short*)(lds + R_QI + tok * R_LD + d * 2) = (unsigned short)f2bf(qraw * __expf(bb));
                    *(LAS unsigned short*)(lds + R_KI + tok * R_LD + d * 2) = (unsigned short)f2bf(kraw * __expf(-bb)); }
                *(LAS unsigned short*)(lds + R_GI + tok * R_LD + d * 2) = (unsigned short)f2bf(kraw * __expf(tot - bb)); }
            if (seg == 0) { *(LAS float*)(lds + R_DEC + d * 4) = __expf(tot); bsum += tot; } }
        __syncthreads();
        f32x16 o;
        if (do_out) {
            if (w < 3) { const int sb = (w == 2) ? 1 : 0, cb = (w == 0) ? 0 : 1; f32x16 x;
#pragma unroll
                for (int i = 0; i < 16; ++i) x[i] = 0.f;
#pragma unroll
                for (int ks = 0; ks < DK / 16; ++ks) { const bf16x8 a = *(const LAS bf16x8*)(lds + R_KI + (sb * 32 + r) * R_LD + (ks * 16 + 8 * h) * 2);
                    const bf16x8 bq = *(const LAS bf16x8*)(lds + R_QI + (cb * 32 + r) * R_LD + (ks * 16 + 8 * h) * 2); x = MFMA32(a, bq, x); }
                const int cc = cb * 32 + r;
#pragma unroll
                for (int g = 0; g < 4; ++g) { float pv[4];
#pragma unroll
                    for (int e = 0; e < 4; ++e) { const int s = sb * 32 + 8 * g + 4 * h + e; pv[e] = (s <= cc) ? x[4 * g + e] : 0.f; }
                    u32x2 wv; wv.x = pk2(pv[0], pv[1]); wv.y = pk2(pv[2], pv[3]);
                    *(LAS u32x2*)(lds + R_PI + cc * R_PLD + (sb * 32 + 8 * g + 4 * h) * 2) = wv; } }
            const int cb = w >> 2;
#pragma unroll
            for (int i = 0; i < 16; ++i) o[i] = 0.f;
#pragma unroll
            for (int ks = 0; ks < DK / 16; ++ks) { const bf16x8 a = *(const LAS bf16x8*)(lds + R_QI + (cb * 32 + r) * R_LD + (ks * 16 + 8 * h) * 2);
                const bf16x8 bs = *(const LAS bf16x8*)(lds + R_ST + (dvb * 32 + r) * R_LD + (ks * 16 + 8 * h) * 2); o = MFMA32(a, bs, o); }
            __syncthreads();
            for (int ks = 0; ks < 2 * (cb + 1); ++ks) { const bf16x8 a = *(const LAS bf16x8*)(lds + R_PI + (cb * 32 + r) * R_PLD + (ks * 16 + 8 * h) * 2);
                const bf16x8 bv = tr_frag(lds + R_VI, ks, dvb, lane); o = MFMA32(a, bv, o); }
#pragma unroll
            for (int i = 0; i < 16; ++i) *(LAS float*)(lds + (cb * 32 + crow(i, h)) * R_OLD + (dvb * 32 + r) * 4) = o[i];
        }
#pragma unroll
        for (int t = 0; t < NQ; ++t) {
#pragma unroll
            for (int i = 0; i < 16; ++i) sacc[t][i] *= *(LAS float*)(lds + R_DEC + ((dkb0 + t) * 32 + crow(i, h)) * 4);
#pragma unroll
            for (int ks = 0; ks < 4; ++ks) { const bf16x8 a = tr_frag(lds + R_GI, ks, dkb0 + t, lane); const bf16x8 bv = tr_frag(lds + R_VI, ks, dvb, lane); sacc[t] = MFMA32(a, bv, sacc[t]); }
            if (OUT) {
#pragma unroll
                for (int g = 0; g < 4; ++g) { u32x2 wv; wv.x = pk2(sacc[t][4 * g], sacc[t][4 * g + 1]); wv.y = pk2(sacc[t][4 * g + 2], sacc[t][4 * g + 3]);
                    *(LAS u32x2*)(lds + R_ST + (dvb * 32 + r) * R_LD + ((dkb0 + t) * 32 + 8 * g + 4 * h) * 2) = wv; } }
        }
        if (do_out) {
            __syncthreads();
            const int row = tid >> 3, sub = tid & 7; f32x4 ov[4]; float ss = 0.f;
#pragma unroll
            for (int q4 = 0; q4 < 4; ++q4) { ov[q4] = *(const LAS f32x4*)(lds + row * R_OLD + sub * 64 + q4 * 16); ss += (ov[q4].x * ov[q4].x + ov[q4].y * ov[q4].y) + (ov[q4].z * ov[q4].z + ov[q4].w * ov[q4].w); }
            ss += __shfl_xor(ss, 1); ss += __shfl_xor(ss, 2); ss += __shfl_xor(ss, 4);
            const float rs = 1.0f / sqrtf(ss * (1.0f / 128.0f) + EPS);
            unsigned ow[8];
#pragma unroll
            for (int q4 = 0; q4 < 4; ++q4) { const f32x4 nv = *(const GAS f32x4*)(ng + sub * 16 + q4 * 4);
                const unsigned g0 = q4 < 2 ? (q4 == 0 ? gt[0].x : gt[0].z) : (q4 == 2 ? gt[1].x : gt[1].z), g1 = q4 < 2 ? (q4 == 0 ? gt[0].y : gt[0].w) : (q4 == 2 ? gt[1].y : gt[1].w);
                ow[2 * q4] = pk2(ov[q4].x * rs * nv.x * bf2f(g0 & 0xffffu), ov[q4].y * rs * nv.y * bf2f(g0 >> 16));
                ow[2 * q4 + 1] = pk2(ov[q4].z * rs * nv.z * bf2f(g1 & 0xffffu), ov[q4].w * rs * nv.w * bf2f(g1 >> 16)); }
            bf16* op = F.OG + (size_t)grow_of(b, c, row) * D + ocol + sub * 16;
            *(GAS v4u*)op = (v4u){ow[0], ow[1], ow[2], ow[3]}; *(GAS v4u*)(op + 8) = (v4u){ow[4], ow[5], ow[6], ow[7]};
        }
        __syncthreads();
    }
    if (!OUT) {
        float* sl = F.SLOC + (size_t)(gidx * 7 + j) * (16 * 64 * 16);
#pragma unroll
        for (int t = 0; t < NQ; ++t) *(GAS f32x16*)(sl + (size_t)((w * 2 + t) * 64 + lane) * 16) = sacc[t];
        if (tid < DK) F.DLOC[(size_t)(gidx * 7 + j) * 128 + tid] = __expf(bsum);
    }
}

struct Args { const float* in[14]; float* out; unsigned char* ws; int ph_lo, ph_hi; };
__global__ void __launch_bounds__(NWAVES * 64, 2) hymba_fwd(Args args) {
    extern __shared__ __attribute__((aligned(16))) unsigned char lds[];
    Frame F;
    F.lds = (LAS unsigned char*)lds;
    F.MISC = (volatile LAS unsigned*)(F.lds + MISC_OFF);
    F.tid = threadIdx.x; F.lane = F.tid & 63; F.wave = __builtin_amdgcn_readfirstlane(F.tid >> 6);
    F.G = gridDim.x;
    unsigned char* ws = args.ws;
    F.ctl = (gu32*)(ws + WS_CTL);
    F.x = args.in[0]; F.meta = args.in[1]; F.lbt = args.in[2]; F.g_mix = args.in[3]; F.w_in = args.in[4]; F.w_up = args.in[5]; F.b_gate = args.in[6];
    F.hgrn_ng = args.in[7]; F.gla_ng = args.in[8]; F.w_out = args.in[9]; F.g_ffn = args.in[10]; F.w_f1 = args.in[11]; F.w_f2 = args.in[12]; F.g_fin = args.in[13];
    F.out = args.out;
    F.WinT = (bf16*)(ws + WS_WIN); F.WoT = (bf16*)(ws + WS_WO); F.W1T = (bf16*)(ws + WS_W1); F.W2T = (bf16*)(ws + WS_W2);
    F.XB = (bf16*)(ws + WS_XB); F.H1B = (bf16*)(ws + WS_XB); F.PROJ = (bf16*)(ws + WS_PROJ); F.HID = (bf16*)(ws + WS_PROJ); F.GLOG = (bf16*)(ws + WS_GLOG); F.OG = (bf16*)(ws + WS_OG);
    F.RSTD0 = (float*)(ws + WS_RSTD0); F.LB = (float*)(ws + WS_LB); F.SSQ1 = (float*)(ws + WS_SSQ1); F.SSQ2 = (float*)(ws + WS_SSQ2); F.DLOC = (float*)(ws + WS_DLOC); F.SLOC = (float*)(ws + WS_SLOC);
    for (int u = F.tid; u < (LDS_BYTES - LDSCTL_OFF) / 4; u += NWAVES * 64) ((LAS unsigned*)(F.lds + LDSCTL_OFF))[u] = 0u;
    __syncthreads();
    XcdBarrier bar; bar.bar = (unsigned*)(F.ctl + CW_BAR); bar.x = 0; bar.st = nullptr;
    if (N_LAUNCHES == 1) bar = xcd_barrier_post((unsigned*)(F.ctl + CW_BAR), F.MISC + 8);
    const int lo = args.ph_lo, hi = args.ph_hi;
#define IN(k) (lo <= (k) && (k) < hi)
#define SEAM(k) do { if (IN(k) && IN((k) + 1)) xcd_barrier(bar); } while (0)

    if (IN(0)) { p0_prologue(F); } SEAM(0);

    if (IN(1)) {
        pg8::Gemm g{F.XB, F.WinT, MP1, NIN, D}; pg8::StaticOrder S; S.init(MP1, NIN, F.G, (int)blockIdx.x);
        EpiProj E{F.PROJ, F.GLOG, F.RSTD0, F.LB, F.b_gate};
        pg8::gemm_phase<EpiProj, pg8::StaticOrder, true, true>(F.lds + RING_OFF, g, S, E);
    } SEAM(1);

    if (IN(2)) {
        for (int uid = blockIdx.x; uid < 2 * 16 * 7; uid += F.G) { const int grp = uid & 1, rest = uid >> 1, j = rest % 7, bh = rest / 7;
            if (grp == 0) rec_unit<128, false>(F, 0, bh, j); else rec_unit<64, false>(F, 1, bh, j); }
    } SEAM(2);

    if (IN(3)) {
        for (int uid = blockIdx.x; uid < 2 * 16 * NSC; uid += F.G) { const int grp = uid & 1, rest = uid >> 1, j = rest & 7, bh = rest >> 3;
            if (grp == 0) rec_unit<128, true>(F, 0, bh, j); else rec_unit<64, true>(F, 1, bh, j); }
    } SEAM(3);

    if (IN(4)) {
        pg8::Gemm g{F.OG, F.WoT, MTOK, D, D}; pg8::StaticOrder S; S.init(MTOK, D, F.G, (int)blockIdx.x);
        EpiRes E{F.x, F.out, F.H1B, F.SSQ1};
        pg8::gemm_phase<EpiRes, pg8::StaticOrder, false, true>(F.lds + RING_OFF, g, S, E);
    } SEAM(4);

    if (IN(5)) {
        pg8::Gemm g{F.H1B, F.W1T, MTOK, NF1, D}; pg8::StaticOrder S; S.init(MTOK, NF1, F.G, (int)blockIdx.x);
        EpiSwiglu E{F.HID, F.SSQ1};
        pg8::gemm_phase<EpiSwiglu, pg8::StaticOrder, true, true>(F.lds + RING_OFF, g, S, E);
    } SEAM(5);

    if (IN(6)) {
        pg8::Gemm g{F.HID, F.W2T, MTOK, D, FFH}; pg8::StaticOrder S; S.init(MTOK, D, F.G, (int)blockIdx.x);
        EpiRes E{F.out, F.out, nullptr, F.SSQ2};
        pg8::gemm_phase<EpiRes, pg8::StaticOrder, false, true>(F.lds + RING_OFF, g, S, E);
    } SEAM(6);

    if (IN(7)) {
        const int gw = blockIdx.x * NWAVES + F.wave, NGW = F.G * NWAVES, lane = F.lane;
        f32x4 gv[4];
#pragma unroll
        for (int q = 0; q < 4; ++q) gv[q] = ((const GAS f32x4*)F.g_fin)[lane + 64 * q];
        for (int m = gw; m < MTOK; m += NGW) {
            const f32x4 s4 = *(const GAS f32x4*)(F.SSQ2 + (size_t)m * 4);
            const float rs = 1.0f / sqrtf(((s4.x + s4.y) + (s4.z + s4.w)) * (1.0f / D) + EPS);
            GAS f32x4* orow = (GAS f32x4*)(F.out + (size_t)m * D) + lane;
#pragma unroll
            for (int q = 0; q < 4; ++q) { f32x4 v = orow[64 * q]; v = v * rs * gv[q]; orow[64 * q] = v; }
        }
    }
#undef IN
#undef SEAM
}

extern "C" void kernel_launch(void* const* d_in, const int* in_sizes, int n_in, void* d_out, int out_size, void* d_ws, size_t ws_size, hipStream_t stream) {
    static int grid = 0;
    if (grid == 0) {
        if (n_in != 14 || in_sizes[0] != MTOK * D || out_size != MTOK * D || ws_size < WS_END) { fprintf(stderr, "kernel_launch: unexpected shapes (n_in %d, in0 %d, out %d, ws %zu); nothing launched\n", n_in, n_in > 0 ? in_sizes[0] : -1, out_size, ws_size); grid = -1; return; }
        int dev = 0, cus = 0, per_cu = 0;
        if (hipGetDevice(&dev) != hipSuccess || hipDeviceGetAttribute(&cus, hipDeviceAttributeMultiprocessorCount, dev) != hipSuccess) { fprintf(stderr, "kernel_launch: device query failed\n"); grid = -1; return; }
        if (hipFuncSetAttribute((const void*)hymba_fwd, hipFuncAttributeMaxDynamicSharedMemorySize, LDS_BYTES) != hipSuccess) { fprintf(stderr, "kernel_launch: hipFuncSetAttribute failed\n"); grid = -1; return; }
        if (hipOccupancyMaxActiveBlocksPerMultiprocessor(&per_cu, (const void*)hymba_fwd, NWAVES * 64, LDS_BYTES) != hipSuccess || per_cu < 1) fprintf(stderr, "kernel_launch: note: occupancy query reports %d workgroups per CU\n", per_cu);
        (void)hipGetLastError();
        grid = cus;
    }
    if (grid < 0) return;
    if (hipMemsetAsync((char*)d_ws + WS_CTL, 0, CTL_ZERO_BYTES, stream) != hipSuccess) { fprintf(stderr, "kernel_launch: hipMemsetAsync failed\n"); return; }
    Args a{};
    for (int i = 0; i < 14; ++i) a.in[i] = (const float*)d_in[i];
    a.out = (float*)d_out; a.ws = (unsigned char*)d_ws;
    for (int li = 0; li < N_LAUNCHES; ++li) {
        a.ph_lo = (N_LAUNCHES == 1) ? 0 : li; a.ph_hi = (N_LAUNCHES == 1) ? NPHASE : li + 1;
        hipLaunchKernelGGL(hymba_fwd, dim3(grid), dim3(NWAVES * 64), LDS_BYTES, stream, a);
        const hipError_t le = hipPeekAtLastError();
        if (le != hipSuccess) { fprintf(stderr, "kernel_launch: launch %d failed: %s\n", li, hipGetErrorName(le)); break; }
    }
}
```
